# Optimizing an MI355X kernel written in HIP

```python
import jax, jax.numpy as jnp
from jax import lax
import numpy as np

D_MODEL = 4096
BATCH = 2
SEQ = 4096
DEPTH = 2

FOX_HEADS = 16
FOX_HEAD_DIM = 128
FOX_WIDTH = FOX_HEADS * FOX_HEAD_DIM
FOX_BLOCK = 128
GLA_HEADS = 4
GLA_KEY_DIM = 256
GLA_VAL_DIM = 512
GLA_KEY_WIDTH = GLA_HEADS * GLA_KEY_DIM
GLA_WIDTH = GLA_HEADS * GLA_VAL_DIM
GLA_GATE_RANK = 16
GLA_GATE_NORMALIZER = 16.0
GLA_CHUNK = 64
MIX_WIDTH = FOX_WIDTH + GLA_WIDTH
IN_SIZES = (FOX_WIDTH, FOX_WIDTH, FOX_WIDTH, FOX_HEADS,
            GLA_KEY_WIDTH, GLA_KEY_WIDTH, GLA_WIDTH, GLA_WIDTH, GLA_GATE_RANK)
VALUE_SLOTS = (2, 6)
IN_COLS = sum(IN_SIZES)
D_FF = 256 * ((8 * D_MODEL + 3 * 256 - 1) // (3 * 256))
ALPHA = (2 * DEPTH) ** 0.25
BETA = (8 * DEPTH) ** -0.25
EPS = 1e-5

kernel_name = "fox_gla_parallel_heads_deepnorm"


def layer_norm(t, g, b):
    t32 = t.astype(jnp.float32)
    mu = jnp.mean(t32, axis=-1, keepdims=True)
    var = jnp.mean(jnp.square(t32 - mu), axis=-1, keepdims=True)
    return ((t32 - mu) * lax.rsqrt(var + EPS) * g + b).astype(t.dtype)


def rms_norm(t, g):
    t32 = t.astype(jnp.float32)
    return t32 * lax.rsqrt(jnp.mean(jnp.square(t32), axis=-1, keepdims=True) + EPS) * g


def fox_attention(q, k, v, c):
    B, H, S, D = q.shape
    n_blocks = S // FOX_BLOCK
    scale = D ** -0.5
    k_pos = jnp.arange(S)

    def block(i):
        start = i * FOX_BLOCK
        qb = lax.dynamic_slice_in_dim(q, start, FOX_BLOCK, axis=2)
        cb = lax.dynamic_slice_in_dim(c, start, FOX_BLOCK, axis=2)
        logits = jnp.einsum('bhqd,bhkd->bhqk', qb, k) * scale + cb[..., :, None] - c[..., None, :]
        q_pos = start + jnp.arange(FOX_BLOCK)
        logits = jnp.where(q_pos[:, None] >= k_pos[None, :], logits, -jnp.inf)
        p = jax.nn.softmax(logits, axis=-1)
        return jnp.einsum('bhqk,bhkd->bhqd', p, v)

    out = lax.map(block, jnp.arange(n_blocks))
    return out.transpose(1, 2, 0, 3, 4).reshape(B, H, S, D)


def gla_chunked(q, k, v, g):
    B, S, H, DK = q.shape
    DV = v.shape[-1]
    n_chunks = S // GLA_CHUNK

    def to_chunks(t):
        return t.reshape(B, n_chunks, GLA_CHUNK, H, t.shape[-1]).transpose(1, 0, 3, 2, 4)

    qc, kc, vc, gc = to_chunks(q), to_chunks(k), to_chunks(v), to_chunks(g)
    bc = jnp.cumsum(gc, axis=-2)
    causal = jnp.tril(jnp.ones((GLA_CHUNK, GLA_CHUNK), dtype=bool))

    def step(state, inp):
        q_, k_, v_, b_ = inp
        b_last = b_[..., -1, :]
        o_inter = jnp.einsum('bhid,bhde->bhie', q_ * jnp.exp(b_), state)
        rel = b_[:, :, :, None, :] - b_[:, :, None, :, :]
        decay = jnp.exp(jnp.where(causal[None, None, :, :, None], rel, -jnp.inf))
        scores = jnp.einsum('bhid,bhjd,bhijd->bhij', q_, k_, decay)
        o_intra = jnp.einsum('bhij,bhje->bhie', scores, v_)
        k_dec = k_ * jnp.exp(b_last[:, :, None, :] - b_)
        state = state * jnp.exp(b_last)[..., None] + jnp.einsum('bhjd,bhje->bhde', k_dec, v_)
        return state, o_inter + o_intra

    state0 = jnp.zeros((B, H, DK, DV), jnp.float32)
    _, out = lax.scan(step, state0, (qc, kc, vc, bc))
    return out.transpose(1, 0, 3, 2, 4).reshape(B, S, H, DV)


def hybrid_mixer(h, w_in, b_f, w_gk_up, b_gk, fox_norm_g, gla_norm_g, w_out):
    B, S, _ = h.shape
    f32 = jnp.float32
    split_at = []
    acc = 0
    for size in IN_SIZES[:-1]:
        acc += size
        split_at.append(acc)
    proj = h @ w_in
    fq, fk, fv, f_logit, gq, gk, gv, gg, g_low = jnp.split(proj, split_at, axis=-1)

    def heads(t):
        return t.reshape(B, S, FOX_HEADS, FOX_HEAD_DIM).transpose(0, 2, 1, 3).astype(f32)
    log_f = jax.nn.log_sigmoid((f_logit + b_f).astype(f32))
    c = jnp.cumsum(log_f, axis=1).transpose(0, 2, 1)
    o_fox = fox_attention(heads(fq), heads(fk), heads(fv), c)
    o_fox = rms_norm(o_fox, fox_norm_g[:, None, :])
    o_fox = o_fox.transpose(0, 2, 1, 3).reshape(B, S, FOX_WIDTH)

    log_a = jax.nn.log_sigmoid((g_low @ w_gk_up + b_gk).astype(f32)) / GLA_GATE_NORMALIZER
    q_g = gq.reshape(B, S, GLA_HEADS, GLA_KEY_DIM).astype(f32) * (GLA_KEY_DIM ** -0.5)
    k_g = gk.reshape(B, S, GLA_HEADS, GLA_KEY_DIM).astype(f32)
    v_g = gv.reshape(B, S, GLA_HEADS, GLA_VAL_DIM).astype(f32)
    a_g = log_a.reshape(B, S, GLA_HEADS, GLA_KEY_DIM)
    o_gla = gla_chunked(q_g, k_g, v_g, a_g)
    gate = jax.nn.silu(gg.reshape(B, S, GLA_HEADS, GLA_VAL_DIM).astype(f32))
    o_gla = (rms_norm(o_gla, gla_norm_g) * gate).reshape(B, S, GLA_WIDTH)

    mixed = jnp.concatenate([o_fox, o_gla], axis=-1).astype(h.dtype)
    return mixed @ w_out


def swiglu(h, w_gate, w_up, w_down):
    return (jax.nn.silu(h @ w_gate) * (h @ w_up)) @ w_down


def setup_inputs(seed: int = 0) -> dict:
    key = jax.random.key(seed)
    ks = jax.random.split(key, 17)
    f32 = jnp.float32

    def nrm(k, shape, scale):
        return jax.random.normal(k, shape, f32) * scale

    col_scale = jnp.concatenate([jnp.full((s,), BETA if i in VALUE_SLOTS else 1.0, f32)
                                 for i, s in enumerate(IN_SIZES)])
    return {
        "x": nrm(ks[0], (BATCH, SEQ, D_MODEL), 1.0),
        "ln_in_g": 1.0 + nrm(ks[1], (D_MODEL,), 0.01),
        "ln_in_b": nrm(ks[2], (D_MODEL,), 0.01),
        "w_in": nrm(ks[3], (DEPTH, D_MODEL, IN_COLS), D_MODEL ** -0.5) * col_scale,
        "b_f": jax.random.uniform(ks[4], (DEPTH, FOX_HEADS), f32, 3.0, 6.0),
        "w_gk_up": nrm(ks[5], (DEPTH, GLA_GATE_RANK, GLA_KEY_WIDTH), GLA_GATE_RANK ** -0.5),
        "b_gk": nrm(ks[6], (DEPTH, GLA_KEY_WIDTH), 0.01),
        "fox_norm_g": 1.0 + nrm(ks[7], (DEPTH, FOX_HEADS, FOX_HEAD_DIM), 0.01),
        "gla_norm_g": 1.0 + nrm(ks[8], (DEPTH, GLA_VAL_DIM), 0.01),
        "w_out": nrm(ks[9], (DEPTH, MIX_WIDTH, D_MODEL), BETA * MIX_WIDTH ** -0.5),
        "ln1_g": 1.0 + nrm(ks[10], (DEPTH, D_MODEL), 0.01),
        "ln1_b": nrm(ks[11], (DEPTH, D_MODEL), 0.01),
        "w_gate": nrm(ks[12], (DEPTH, D_MODEL, D_FF), BETA * D_MODEL ** -0.5),
        "w_up": nrm(ks[13], (DEPTH, D_MODEL, D_FF), BETA * D_MODEL ** -0.5),
        "w_down": nrm(ks[14], (DEPTH, D_FF, D_MODEL), BETA * D_FF ** -0.5),
        "ln2_g": 1.0 + nrm(ks[15], (DEPTH, D_MODEL), 0.01),
        "ln2_b": nrm(ks[16], (DEPTH, D_MODEL), 0.01),
    }


def reference(x, ln_in_g, ln_in_b, w_in, b_f, w_gk_up, b_gk, fox_norm_g, gla_norm_g,
              w_out, ln1_g, ln1_b, w_gate, w_up, w_down, ln2_g, ln2_b):
    x = layer_norm(x, ln_in_g, ln_in_b)
    for l in range(DEPTH):
        mix = hybrid_mixer(x, w_in[l], b_f[l], w_gk_up[l], b_gk[l],
                           fox_norm_g[l], gla_norm_g[l], w_out[l])
        x = layer_norm(ALPHA * x + mix, ln1_g[l], ln1_b[l])
        ffn = swiglu(x, w_gate[l], w_up[l], w_down[l])
        x = layer_norm(ALPHA * x + ffn, ln2_g[l], ln2_b[l])
    return x
```

```cpp
#include <hip/hip_runtime.h>
#include <hip/hip_bf16.h>
#include <cstdio>
#include <cstdint>
namespace pg8 {
#define PG8_LAS __attribute__((address_space(3)))
typedef unsigned short bf16_t;
typedef short bf16x8 __attribute__((ext_vector_type(8)));
typedef float f32x4 __attribute__((ext_vector_type(4)));
typedef unsigned u32x4 __attribute__((ext_vector_type(4)));
constexpr int BM = 256, BK = 64, HALF = 128, HTB = HALF * BK * 2  , STAGE_BYTES = 8 * HTB, NXCD = 8, WGM = 8;

__host__ __device__ __forceinline__ int lds_byte(int r, int c) { const int st = (r >> 4) * 2 + (c >> 5), rr = r & 15, cc = c & 31, ob = rr * 64 + cc * 2; return st * 1024 + (ob ^ (((ob >> 9) & 1) << 5)); }
__host__ __device__ __forceinline__ void stage_rc(int b, int& R, int& C) { const int st = b / 1024, sb = b % 1024, swz = sb ^ (((sb >> 9) & 1) << 5); R = (st >> 1) * 16 + swz / 64; C = (st & 1) * 32 + (swz % 64) / 2; }
__host__ __device__ __forceinline__ int perm32(int rho) { const int n = rho >> 4, i = rho & 15; return 8 * (i >> 2) + 4 * n + (i & 3); }

struct Unit { int pm, pn; };
struct Gemm { const bf16_t* A; const bf16_t* Bt; int M, N, K; };

struct StaticOrder {
    int nM, nN, nwg, G, c;
    __host__ __device__ void init(int M, int N, int G_, int c_) { nM = M / BM; nN = N / BM; nwg = nM * nN; G = G_; c = c_; }
    __host__ __device__ bool next(int i, Unit& u) const {
        const long L = (long)i * G + c; if (L >= nwg) return false;
        int wgid = (int)L; { const int q = nwg / NXCD, r = nwg % NXCD, xcd = wgid % NXCD, off = wgid / NXCD; wgid = (xcd < r ? xcd * (q + 1) : r * (q + 1) + (xcd - r) * q) + off; }
        const int nig = WGM * nN, gid = wgid / nig, fm = gid * WGM, gsz = (nM - fm) < WGM ? (nM - fm) : WGM;
        u.pm = fm + ((wgid % nig) % gsz); u.pn = (wgid % nig) / gsz; return true;
    }
    __device__ __forceinline__ void a_ready(const Unit&) const {}
    __device__ __forceinline__ void done(const Unit&) const {}
};

__device__ __forceinline__ unsigned cvt_pk_bf16(float lo, float hi) { unsigned r; asm volatile("v_cvt_pk_bf16_f32 %0, %1, %2" : "=v"(r) : "v"(lo), "v"(hi)); return r; }
struct EpiF32 {
    static constexpr bool PERM = false, AFTER_DRAIN = false;
    float* C; int ldc;
    __device__ __forceinline__ void operator()(const f32x4 (&acc)[2][2][4][2], const Unit& u, int wr, int wc, int fr, int fq) const {
        const int row0 = u.pm * BM + wr * 64 + fr, col0 = u.pn * BM + wc * 32 + 4 * fq;
#pragma unroll
        for (int ai = 0; ai < 2; ++ai)
#pragma unroll
            for (int m = 0; m < 4; ++m) { float* rowp = C + (size_t)(row0 + ai * HALF + m * 16) * ldc + col0;
#pragma unroll
                for (int bj = 0; bj < 2; ++bj)
#pragma unroll
                    for (int n = 0; n < 2; ++n) *(f32x4*)(rowp + bj * HALF + n * 16) = acc[ai][bj][m][n]; }
    }
};
struct EpiBf16Plain {
    static constexpr bool PERM = true, AFTER_DRAIN = false;
    bf16_t* O; int ldc;
    __device__ __forceinline__ void operator()(const f32x4 (&acc)[2][2][4][2], const Unit& u, int wr, int wc, int fr, int fq) const {
        const int row0 = u.pm * BM + wr * 64 + fr, col0 = u.pn * BM + wc * 32 + 8 * fq;
#pragma unroll
        for (int ai = 0; ai < 2; ++ai)
#pragma unroll
            for (int m = 0; m < 4; ++m) { bf16_t* rowp = O + (size_t)(row0 + ai * HALF + m * 16) * ldc + col0;
#pragma unroll
                for (int bj = 0; bj < 2; ++bj) { const f32x4 v0 = acc[ai][bj][m][0], v1 = acc[ai][bj][m][1];
                    u32x4 w; w.x = cvt_pk_bf16(v0[0], v0[1]); w.y = cvt_pk_bf16(v0[2], v0[3]); w.z = cvt_pk_bf16(v1[0], v1[1]); w.w = cvt_pk_bf16(v1[2], v1[3]);
                    *(u32x4*)(rowp + bj * HALF) = w; } }
    }
};
struct EpiProj {
    static constexpr bool PERM = true, AFTER_DRAIN = false;
    unsigned char* ws;
    __device__ __forceinline__ void operator()(const f32x4 (&acc)[2][2][4][2], const Unit& u, int wr, int wc, int fr, int fq) const {
        const int pn = u.pn, rowt = u.pm * BM;
        size_t boff; int ld, bjs, rbase;
        if (pn < 24) { const int which = pn >> 3, hp = pn & 7, b = rowt >> 12; boff = (264ull << 20) + ((size_t)which << 25) + (size_t)(b * 16 + 2 * hp) * (4096 * 128 * 2); ld = 128; bjs = 4096 * 128; rbase = rowt & 4095; }
        else if (pn < 28) { boff = (360ull << 20) + (size_t)(pn - 24) * 512; ld = 1024; bjs = 128; rbase = rowt; }
        else if (pn < 32) { boff = (376ull << 20) + (size_t)(pn - 28) * 512; ld = 1024; bjs = 128; rbase = rowt; }
        else { boff = (392ull << 20) + (size_t)(pn - 32) * 512; ld = 2048; bjs = 128; rbase = rowt; }
        bf16_t* base = (bf16_t*)(ws + boff);
        const int row0 = rbase + wr * 64 + fr, cw = wc * 32 + 8 * fq;
#pragma unroll
        for (int ai = 0; ai < 2; ++ai)
#pragma unroll
            for (int m = 0; m < 4; ++m) { bf16_t* rowp = base + (size_t)(row0 + ai * HALF + m * 16) * ld + cw;
#pragma unroll
                for (int bj = 0; bj < 2; ++bj) { const f32x4 v0 = acc[ai][bj][m][0], v1 = acc[ai][bj][m][1];
                    u32x4 w; w.x = cvt_pk_bf16(v0[0], v0[1]); w.y = cvt_pk_bf16(v0[2], v0[3]); w.z = cvt_pk_bf16(v1[0], v1[1]); w.w = cvt_pk_bf16(v1[2], v1[3]);
                    *(u32x4*)(rowp + (size_t)bj * bjs) = w; } }
    }
};
struct EpiSwiglu {
    static constexpr bool PERM = true, AFTER_DRAIN = false;
    bf16_t* Hh; int ldh;
    __device__ __forceinline__ void operator()(const f32x4 (&acc)[2][2][4][2], const Unit& u, int wr, int wc, int fr, int fq) const {
        const int row0 = u.pm * BM + wr * 64 + fr, col0 = u.pn * HALF + wc * 32 + 8 * fq;
#pragma unroll
        for (int ai = 0; ai < 2; ++ai)
#pragma unroll
            for (int m = 0; m < 4; ++m) { bf16_t* rowp = Hh + (size_t)(row0 + ai * HALF + m * 16) * ldh + col0;
                float o[8];
#pragma unroll
                for (int n = 0; n < 2; ++n)
#pragma unroll
                    for (int e = 0; e < 4; ++e) { const float g = acc[ai][0][m][n][e], up = acc[ai][1][m][n][e];
                        o[n * 4 + e] = g * up * __builtin_amdgcn_rcpf(1.0f + __expf(-g)); }
                u32x4 w; w.x = cvt_pk_bf16(o[0], o[1]); w.y = cvt_pk_bf16(o[2], o[3]); w.z = cvt_pk_bf16(o[4], o[5]); w.w = cvt_pk_bf16(o[6], o[7]);
                *(u32x4*)rowp = w; }
    }
};
template <class Epi, class Sched, bool ALIGN_EPI = false, bool SP2 = false>
__device__ __forceinline__ void gemm_phase(PG8_LAS unsigned char* lds, const Gemm g, const Sched& S, const Epi& E, const int tid_in) {
    int tid_ = tid_in; asm volatile("" : "+v"(tid_)); __builtin_assume(tid_ >= 0 && tid_ < 512);
    const int tid = tid_, wid = __builtin_amdgcn_readfirstlane(tid >> 6), lane = tid & 63, wr = wid >> 2, wc = wid & 3, fr = lane & 15, fq = lane >> 4;
    const int K = g.K, nt = K / BK;
    unsigned voffA[2], voffB[2];
#pragma unroll
    for (int i = 0; i < 2; ++i) { int R, C; stage_rc(tid * 16 + i * 8192, R, C); const int Rb = Epi::PERM ? ((R & ~31) + perm32(R & 31)) : R;
        voffA[i] = (unsigned)(R * K + C) * 2u; voffB[i] = (unsigned)(Rb * K + C) * 2u; }
    const size_t kstep = (size_t)(BK * 2);
    const size_t hstep = (size_t)HALF * K * 2;
    const size_t tstep = 2 * hstep;
    const unsigned ldsw = (unsigned)wid * 1024u;
    const int aoff = lds_byte(wr * 64 + fr, fq * 8), boff = lds_byte(wc * 32 + fr, fq * 8);
#define PG8_SA(b, h) (((b) * 2 + (h)) * HTB)
#define PG8_SB(b, h) ((4 + (b) * 2 + (h)) * HTB)
#define PG8_STAGE(bufoff, gbase, voff) do { _Pragma("unroll") for (int _i = 0; _i < 2; ++_i) \
        __builtin_amdgcn_global_load_lds((const unsigned*)((const char*)(gbase) + (voff)[_i]), (PG8_LAS unsigned*)(lds + (bufoff) + ldsw + _i * 8192), 16, 0, 0); } while (0)
#define PG8_LDA(dst, b, h) do { _Pragma("unroll") for (int m = 0; m < 4; ++m) _Pragma("unroll") for (int k = 0; k < 2; ++k) dst[m][k] = *(const PG8_LAS bf16x8*)(lds + PG8_SA(b, h) + aoff + m * 2048 + k * 1024); } while (0)
#define PG8_LDB(dst, b, h) do { _Pragma("unroll") for (int n = 0; n < 2; ++n) _Pragma("unroll") for (int k = 0; k < 2; ++k) dst[n][k] = *(const PG8_LAS bf16x8*)(lds + PG8_SB(b, h) + boff + n * 2048 + k * 1024); } while (0)
#define PG8_MMA(ai, bj, At, Bt) do { __builtin_amdgcn_s_setprio(1); _Pragma("unroll") for (int m = 0; m < 4; ++m) _Pragma("unroll") for (int n = 0; n < 2; ++n) _Pragma("unroll") for (int k = 0; k < 2; ++k) \
        acc[ai][bj][m][n] = __builtin_amdgcn_mfma_f32_16x16x32_bf16(Bt[n][k], At[m][k], acc[ai][bj][m][n], 0, 0, 0); __builtin_amdgcn_s_setprio(0); } while (0)
#define PG8_WAIT_V(n) asm volatile("s_waitcnt vmcnt(" #n ")" ::: "memory")
#define PG8_WAIT_L(n) asm volatile("s_waitcnt lgkmcnt(" #n ")" ::: "memory")
#define PG8_BAR __builtin_amdgcn_s_barrier()
#define PG8_SCHED __builtin_amdgcn_sched_barrier(0)
    Unit cur, nxt; int ui = 0;
    if (!S.next(0, cur)) return;
    f32x4 acc[2][2][4][2];
#pragma unroll
    for (int a = 0; a < 2; ++a)
#pragma unroll
        for (int b = 0; b < 2; ++b)
#pragma unroll
            for (int m = 0; m < 4; ++m)
#pragma unroll
                for (int n = 0; n < 2; ++n) acc[a][b][m][n] = (f32x4){0.f, 0.f, 0.f, 0.f};
    bf16x8 At[4][2], B0[2][2], B1[2][2];
    const char* cA = (const char*)g.A + (size_t)cur.pm * tstep; const char* cB = (const char*)g.Bt + (size_t)cur.pn * tstep;
    S.a_ready(cur);
    if constexpr (SP2) {
        PG8_STAGE(PG8_SB(0, 0), cB, voffB); PG8_STAGE(PG8_SB(0, 1), cB + hstep, voffB); PG8_STAGE(PG8_SA(0, 0), cA, voffA); PG8_STAGE(PG8_SA(0, 1), cA + hstep, voffA);
        if (wr == 1) PG8_BAR;
        PG8_WAIT_V(2); PG8_BAR;
        PG8_STAGE(PG8_SB(1, 0), cB + kstep, voffB); PG8_STAGE(PG8_SA(1, 0), cA + kstep, voffA); PG8_STAGE(PG8_SB(1, 1), cB + hstep + kstep, voffB);
        PG8_WAIT_V(6); PG8_BAR;
    } else {
        PG8_STAGE(PG8_SB(0, 0), cB, voffB); PG8_STAGE(PG8_SA(0, 0), cA, voffA); PG8_STAGE(PG8_SB(0, 1), cB + hstep, voffB); PG8_STAGE(PG8_SA(0, 1), cA + hstep, voffA);
        if (wr == 1) PG8_BAR;
        PG8_WAIT_V(4); PG8_BAR;
        PG8_STAGE(PG8_SB(1, 0), cB + kstep, voffB); PG8_STAGE(PG8_SA(1, 0), cA + kstep, voffA); PG8_STAGE(PG8_SB(1, 1), cB + hstep + kstep, voffB);
        PG8_WAIT_V(6); PG8_BAR;
    }
    for (;;) {
        const bool has_next = S.next(ui + 1, nxt);
        const char* nA = has_next ? (const char*)g.A + (size_t)nxt.pm * tstep : cA; const char* nB = has_next ? (const char*)g.Bt + (size_t)nxt.pn * tstep : cB;
        for (int t = 0; t < nt; t += 2) {
            const bool last = (t == nt - 2);
            const char* a1 = cA + (size_t)(t + 1) * kstep;
            const char* a2 = last ? nA : cA + (size_t)(t + 2) * kstep; const char* b2 = last ? nB : cB + (size_t)(t + 2) * kstep;
            const char* a3 = a2 + kstep; const char* b3 = b2 + kstep;
            if (last && has_next) S.a_ready(nxt);
            if constexpr (SP2) {
            PG8_LDB(B0, 0, 0); PG8_LDB(B1, 0, 1); PG8_SCHED; PG8_LDA(At, 0, 0); PG8_STAGE(PG8_SA(1, 1), a1 + hstep, voffA);
            PG8_WAIT_V(8); PG8_WAIT_L(0); PG8_BAR; PG8_MMA(0, 0, At, B0); PG8_MMA(0, 1, At, B1); PG8_BAR; PG8_SCHED;
            PG8_LDA(At, 0, 1); PG8_STAGE(PG8_SB(0, 0), b2, voffB); PG8_STAGE(PG8_SB(0, 1), b2 + hstep, voffB); PG8_STAGE(PG8_SA(0, 0), a2, voffA);
            PG8_WAIT_V(8); PG8_WAIT_L(0); PG8_BAR; PG8_MMA(1, 0, At, B0); PG8_MMA(1, 1, At, B1); PG8_BAR; PG8_SCHED;
            PG8_LDB(B0, 1, 0); PG8_LDB(B1, 1, 1); PG8_SCHED; PG8_LDA(At, 1, 0); PG8_STAGE(PG8_SA(0, 1), a2 + hstep, voffA);
            PG8_WAIT_V(8); PG8_WAIT_L(0); PG8_BAR; PG8_MMA(0, 0, At, B0); PG8_MMA(0, 1, At, B1); PG8_BAR; PG8_SCHED;
            PG8_LDA(At, 1, 1); PG8_STAGE(PG8_SB(1, 0), b3, voffB); PG8_STAGE(PG8_SB(1, 1), b3 + hstep, voffB); PG8_STAGE(PG8_SA(1, 0), a3, voffA);
            PG8_WAIT_V(8); PG8_WAIT_L(0); PG8_BAR; PG8_MMA(1, 0, At, B0); PG8_MMA(1, 1, At, B1); PG8_BAR; PG8_SCHED;
            } else {
            PG8_LDB(B0, 0, 0); PG8_SCHED; PG8_LDA(At, 0, 0); PG8_STAGE(PG8_SA(1, 1), a1 + hstep, voffA);
            PG8_WAIT_L(8); PG8_BAR; PG8_WAIT_L(0); PG8_MMA(0, 0, At, B0); PG8_BAR; PG8_SCHED;
            PG8_LDB(B1, 0, 1); PG8_STAGE(PG8_SB(0, 0), b2, voffB);
            PG8_BAR; PG8_WAIT_L(0); PG8_MMA(0, 1, At, B1); PG8_BAR;
            PG8_LDA(At, 0, 1); PG8_STAGE(PG8_SA(0, 0), a2, voffA);
            PG8_BAR; PG8_WAIT_L(0); PG8_MMA(1, 0, At, B0); PG8_BAR; PG8_SCHED;
            PG8_STAGE(PG8_SB(0, 1), b2 + hstep, voffB);
            PG8_WAIT_V(6); PG8_BAR; PG8_MMA(1, 1, At, B1); PG8_BAR;
            PG8_LDB(B0, 1, 0); PG8_SCHED; PG8_LDA(At, 1, 0); PG8_STAGE(PG8_SA(0, 1), a2 + hstep, voffA);
            PG8_WAIT_L(8); PG8_BAR; PG8_WAIT_L(0); PG8_MMA(0, 0, At, B0); PG8_BAR; PG8_SCHED;
            PG8_LDB(B1, 1, 1); PG8_STAGE(PG8_SB(1, 0), b3, voffB);
            PG8_BAR; PG8_WAIT_L(0); PG8_MMA(0, 1, At, B1); PG8_BAR;
            PG8_LDA(At, 1, 1); PG8_STAGE(PG8_SA(1, 0), a3, voffA);
            PG8_BAR; PG8_WAIT_L(0); PG8_MMA(1, 0, At, B0); PG8_BAR; PG8_SCHED;
            PG8_STAGE(PG8_SB(1, 1), b3 + hstep, voffB);
            PG8_WAIT_V(6); PG8_BAR; PG8_MMA(1, 1, At, B1); PG8_BAR;
            }
        }
        if constexpr (ALIGN_EPI) { if (wr == 0) PG8_BAR; }
        if constexpr (!Epi::AFTER_DRAIN) { E(acc, cur, wr, wc, fr, fq); S.done(cur); }
        if (!has_next) break;
#pragma unroll
        for (int a = 0; a < 2; ++a)
#pragma unroll
            for (int b = 0; b < 2; ++b)
#pragma unroll
                for (int m = 0; m < 4; ++m)
#pragma unroll
                    for (int n = 0; n < 2; ++n) acc[a][b][m][n] = (f32x4){0.f, 0.f, 0.f, 0.f};
        cur = nxt; cA = nA; cB = nB; ++ui;
        if constexpr (ALIGN_EPI) { if (wr == 1) PG8_BAR; }
    }
    PG8_WAIT_V(0);
    if constexpr (!ALIGN_EPI) { if (wr == 0) PG8_BAR; }
    PG8_BAR;
    if constexpr (Epi::AFTER_DRAIN) { E.fused(acc, cur, wr, wc, fr, fq, lds, wid, lane); S.done(cur); }
#undef PG8_SA
#undef PG8_SB
#undef PG8_STAGE
#undef PG8_LDA
#undef PG8_LDB
#undef PG8_MMA
#undef PG8_WAIT_V
#undef PG8_WAIT_L
#undef PG8_BAR
#undef PG8_SCHED
}
}
namespace fox {
using TIN = __hip_bfloat16; using TOUT = float;
constexpr int B = 2, H = 16, HKV = 16, SQ = 4096, SKV = 4096, D = 128;
constexpr int QOFF = 0, WINDOW = SKV;
constexpr float THR = 8.f;
constexpr bool WSKIP = false;
enum { ORDER_NATURAL = 0, ORDER_REVERSED = 1, ORDER_PAIRED = 2, ORDER_XCD = 4 };
constexpr float SCALE = 0.08838834764831845f;
constexpr int NW = 8, QBLK = 32, KVBLK = 64, QB = NW * QBLK;
constexpr int SHM_V = KVBLK * D * 2, SHM_K = KVBLK * D * 2;
constexpr int BIAS_OFF = 2 * SHM_V + 2 * SHM_K + NW * 64 * 4;
constexpr int LDS_BYTES = BIAS_OFF + SKV * 4;
static_assert(D == 128 && SQ % QB == 0 && SKV % KVBLK == 0 && H % HKV == 0 && QOFF >= 0 && QOFF + SQ <= SKV && WINDOW >= 1, "geometry");

using bf16 = __hip_bfloat16;
typedef short bf16x8 __attribute__((ext_vector_type(8)));
typedef short s16x4 __attribute__((ext_vector_type(4)));
typedef float f32x16 __attribute__((ext_vector_type(16)));
typedef float f32x4 __attribute__((ext_vector_type(4)));
typedef unsigned u32x4 __attribute__((ext_vector_type(4)));
template <class A, class Bt> struct same_t { static constexpr bool v = false; };
template <class A> struct same_t<A, A> { static constexpr bool v = true; };

#define KSWZ(row, colB) ((row) * 256 + ((colB) ^ (((row) & 7) << 4)))
#define SBAR() __builtin_amdgcn_sched_barrier(0)
__device__ __forceinline__ int v_st(int k, int c) { const int kk = (k & ~0xC) | ((k & 4) << 1) | ((k & 8) >> 1); return ((kk >> 3) * 4 + (c >> 5)) * 512 + ((kk & 7) * 32 + (c & 31)) * 2; }
__device__ __forceinline__ int v_rd_base(int lane) { return ((lane & 3) << 3) | (((lane >> 2) & 3) << 6) | (((lane >> 4) & 1) << 5) | (((lane >> 5) & 1) << 8); }
constexpr int v_rd_off(int d0, int ks, int half) { return d0 * 512 + ks * 4096 + half * 2048; }
__device__ __forceinline__ int crow(int r, int hi) { return (r & 3) + 8 * (r >> 2) + 4 * hi; }
__device__ __forceinline__ unsigned cvtpk(float lo, float hi) {
    unsigned r; asm volatile("v_cvt_pk_bf16_f32 %0, %1, %2" : "=v"(r) : "v"(lo), "v"(hi)); return r;
}
__device__ __forceinline__ bf16x8 pack8(f32x4 a, f32x4 b) {
    u32x4 w = {cvtpk(a[0], a[1]), cvtpk(a[2], a[3]), cvtpk(b[0], b[1]), cvtpk(b[2], b[3])};
    return *reinterpret_cast<bf16x8*>(&w);
}
template <class T> __device__ __forceinline__ bf16x8 load8(const T* p) {
    if constexpr (same_t<T, float>::v) { return pack8(*(const f32x4*)p, *(const f32x4*)(p + 4)); }
    else { return *reinterpret_cast<const bf16x8*>(p); }
}
__device__ __forceinline__ void mask_tile(f32x16& p0, f32x16& p1, int dq, unsigned W) {
    const float NEG = -__builtin_inff();
#pragma unroll
    for (int r = 0; r < 16; ++r) {
        const int c = (r & 3) + 8 * (r >> 2);
        if ((unsigned)(dq - c) >= W) p0[r] = NEG;
        if ((unsigned)(dq - c - 32) >= W) p1[r] = NEG;
    }
}
__device__ __forceinline__ void partialSM(f32x16& p0, f32x16& p1, float& m_reg, float& mn, float& alpha) {
    float pmax = p0[0]; for (int r = 1; r < 16; ++r) pmax = fmaxf(pmax, p0[r]); for (int r = 0; r < 16; ++r) pmax = fmaxf(pmax, p1[r]);
    { auto rr = __builtin_amdgcn_permlane32_swap(__float_as_uint(pmax), __float_as_uint(pmax), false, false);
      pmax = fmaxf(__uint_as_float(rr[0]), __uint_as_float(rr[1])); }
    constexpr float C2 = 1.4426950408889634f * SCALE;
    if (__builtin_expect(__all((pmax - m_reg) * SCALE <= THR), 1)) { mn = m_reg; alpha = 1.f; }
    else { mn = fmaxf(m_reg, pmax); alpha = __builtin_amdgcn_exp2f((m_reg - mn) * C2); m_reg = mn; }
    const float mnL = -mn * C2;
    for (int r = 0; r < 16; ++r) p0[r] = fmaf(p0[r], C2, mnL); for (int r = 0; r < 16; ++r) p1[r] = fmaf(p1[r], C2, mnL);
    for (int r = 0; r < 16; ++r) p0[r] = __builtin_amdgcn_exp2f(p0[r]);
}
__device__ __forceinline__ void finishSM(f32x16& p0, f32x16& p1, float alpha, float& l_reg, bf16x8& pa0, bf16x8& pa1, bf16x8& pa2, bf16x8& pa3) {
    for (int r = 0; r < 16; ++r) p1[r] = __builtin_amdgcn_exp2f(p1[r]);
    float ps = 0; for (int r = 0; r < 16; ++r) ps += p0[r]; for (int r = 0; r < 16; ++r) ps += p1[r];
    { auto rr = __builtin_amdgcn_permlane32_swap(__float_as_uint(ps), __float_as_uint(ps), false, false);
      ps = __uint_as_float(rr[0]) + __uint_as_float(rr[1]); }
    l_reg = l_reg * alpha + ps;
#define PK4(P, B_, OUT) do { unsigned a0 = cvtpk(P[B_+0], P[B_+1]), a1 = cvtpk(P[B_+2], P[B_+3]);                          \
        unsigned b0 = cvtpk(P[B_+4], P[B_+5]), b1 = cvtpk(P[B_+6], P[B_+7]);                                             \
        auto r0 = __builtin_amdgcn_permlane32_swap(a0, b0, false, false); auto r1 = __builtin_amdgcn_permlane32_swap(a1, b1, false, false); \
        u32x4 w = {r0[0], r1[0], r0[1], r1[1]}; OUT = *reinterpret_cast<bf16x8*>(&w); } while (0)
    PK4(p0, 0, pa0); PK4(p0, 8, pa1); PK4(p1, 0, pa2); PK4(p1, 8, pa3);
#undef PK4
}
template <int KB, bool SK>
__device__ __forceinline__ void qkt(f32x16& p0, f32x16& p1, const char* K_lds, int r32, int hi, const bf16x8* qr, bool act, const float* bt) {
    if (SK && !act) { const float NEG = -__builtin_inff();
#pragma unroll
        for (int r = 0; r < 16; ++r) { p0[r] = NEG; p1[r] = NEG; } return; }
    p0 = f32x16{}; p1 = f32x16{};
    const char* kb[4];
#pragma unroll
    for (int dd = 0; dd < 4; ++dd) kb[dd] = K_lds + KB * SHM_K + KSWZ(r32, (dd * 16 + hi * 8) * 2);
#pragma unroll
    for (int d0 = 0; d0 < 8; ++d0) { const char* a = kb[d0 & 3] + (d0 >> 2) * 128;
        bf16x8 b0 = *reinterpret_cast<const bf16x8*>(a);
        bf16x8 b1 = *reinterpret_cast<const bf16x8*>(a + 32 * 256);
        p0 = __builtin_amdgcn_mfma_f32_32x32x16_bf16(b0, qr[d0], p0, 0, 0, 0);
        p1 = __builtin_amdgcn_mfma_f32_32x32x16_bf16(b1, qr[d0], p1, 0, 0, 0); }
    { const float x0 = bt[r32], x1 = bt[32 + r32];
      const unsigned h0 = cvtpk(x0, x0) & 0xffffu; const float r0 = x0 - __uint_as_float(h0 << 16); const unsigned m0 = cvtpk(r0, r0) & 0xffffu; const float s0 = r0 - __uint_as_float(m0 << 16); const unsigned l0 = cvtpk(s0, s0) & 0xffffu;
      const unsigned h1 = cvtpk(x1, x1) & 0xffffu; const float r1 = x1 - __uint_as_float(h1 << 16); const unsigned m1 = cvtpk(r1, r1) & 0xffffu; const float s1 = r1 - __uint_as_float(m1 << 16); const unsigned l1 = cvtpk(s1, s1) & 0xffffu;
      const u32x4 ka0 = {h0 | (m0 << 16), l0, 0u, 0u}, ka1 = {h1 | (m1 << 16), l1, 0u, 0u};
      const u32x4 qo = {hi ? 0u : 0x3F803F80u, hi ? 0u : 0x00003F80u, 0u, 0u};
      p0 = __builtin_amdgcn_mfma_f32_32x32x16_bf16(*reinterpret_cast<const bf16x8*>(&ka0), *reinterpret_cast<const bf16x8*>(&qo), p0, 0, 0, 0);
      p1 = __builtin_amdgcn_mfma_f32_32x32x16_bf16(*reinterpret_cast<const bf16x8*>(&ka1), *reinterpret_cast<const bf16x8*>(&qo), p1, 0, 0, 0); }
}
template <int VB, bool SK>
__device__ __forceinline__ void pv_tile(f32x16* o, int vb0, bf16x8 pa0, bf16x8 pa1, bf16x8 pa2, bf16x8 pa3, bool act) {
    if (SK && !act) return;
#define TRRD(dst, off) asm volatile("ds_read_b64_tr_b16 %0, %1 offset:%2" : "=&v"(dst) : "v"(vb0), "i"(off) : "memory")
#define PV_D0(d0) do { s16x4 l0, l1, l2, l3, h0, h1, h2, h3; constexpr int b_ = VB * SHM_V + v_rd_off(d0, 0, 0);     \
        TRRD(l0, b_); TRRD(h0, b_ + 2048); TRRD(l1, b_ + 4096); TRRD(h1, b_ + 6144); TRRD(l2, b_ + 8192); TRRD(h2, b_ + 10240); TRRD(l3, b_ + 12288); TRRD(h3, b_ + 14336); \
        asm volatile("s_waitcnt lgkmcnt(0)" ::: "memory"); SBAR();                 \
        o[d0] = __builtin_amdgcn_mfma_f32_32x32x16_bf16(pa0, (bf16x8){l0[0], l0[1], l0[2], l0[3], h0[0], h0[1], h0[2], h0[3]}, o[d0], 0, 0, 0);   \
        o[d0] = __builtin_amdgcn_mfma_f32_32x32x16_bf16(pa1, (bf16x8){l1[0], l1[1], l1[2], l1[3], h1[0], h1[1], h1[2], h1[3]}, o[d0], 0, 0, 0);   \
        o[d0] = __builtin_amdgcn_mfma_f32_32x32x16_bf16(pa2, (bf16x8){l2[0], l2[1], l2[2], l2[3], h2[0], h2[1], h2[2], h2[3]}, o[d0], 0, 0, 0);   \
        o[d0] = __builtin_amdgcn_mfma_f32_32x32x16_bf16(pa3, (bf16x8){l3[0], l3[1], l3[2], l3[3], h3[0], h3[1], h3[2], h3[3]}, o[d0], 0, 0, 0); } while (0)
    PV_D0(0); PV_D0(1); PV_D0(2); PV_D0(3);
#undef PV_D0
#undef TRRD
}

template <class TIn, class TOut> struct BlockRef { const TIn* Q; const TIn* K; const TIn* V; TOut* O; int P0; const float* KB; };
template <class TIn> struct Seam {
    bf16x8 qr[8];
    bf16x8 st_v0, st_v1, st_k0, st_k1; f32x4 sf0, sf1, sf2, sf3;
    f32x4 tq[16];
};
__device__ __forceinline__ int swa_jlo(int P0, int W) { const int lowk = P0 - W + 1; return lowk > 0 ? lowk / KVBLK : 0; }
#define ROW(p, k0, rr) ((p) + (size_t)((k0) + (rr)) * D + sc)
#define VMW() asm volatile("s_waitcnt vmcnt(0)" ::: "memory")
#define VMWN(n) asm volatile("s_waitcnt vmcnt(%0)" :: "i"(n) : "memory")
#define SLOAD_H(Kp, Vp, k0) do { S.st_v0 = load8<TIn>(ROW(Vp, k0, sr)); S.st_v1 = load8<TIn>(ROW(Vp, k0, 32 + sr));              \
                         S.st_k0 = load8<TIn>(ROW(Kp, k0, sr)); S.st_k1 = load8<TIn>(ROW(Kp, k0, 32 + sr)); } while (0)
#define SWRITE_HK(bf) do { *(bf16x8*)(K_lds + (bf) * SHM_K + kws) = S.st_k0; *(bf16x8*)(K_lds + (bf) * SHM_K + kws + 32 * 256) = S.st_k1; } while (0)
#define SWRITE_HV(bf) do { *(bf16x8*)(V_lds + (bf) * SHM_V + vst0) = S.st_v0; *(bf16x8*)(V_lds + (bf) * SHM_V + vst1) = S.st_v1; } while (0)
#define SWRITE_H(bf) do { SWRITE_HV(bf); SWRITE_HK(bf); } while (0)
#define SLOAD_F(p, k0) do { S.sf0 = *(const f32x4*)ROW(p, k0, sr); S.sf1 = *(const f32x4*)(ROW(p, k0, sr) + 4);                \
                            S.sf2 = *(const f32x4*)ROW(p, k0, 32 + sr); S.sf3 = *(const f32x4*)(ROW(p, k0, 32 + sr) + 4); } while (0)
#define SWRITE_KF(bf) do { *(bf16x8*)(K_lds + (bf) * SHM_K + kws) = pack8(S.sf0, S.sf1); *(bf16x8*)(K_lds + (bf) * SHM_K + kws + 32 * 256) = pack8(S.sf2, S.sf3); } while (0)
#define SWRITE_VF(bf) do { *(bf16x8*)(V_lds + (bf) * SHM_V + vst0) = pack8(S.sf0, S.sf1); *(bf16x8*)(V_lds + (bf) * SHM_V + vst1) = pack8(S.sf2, S.sf3); } while (0)
template <class TIn, class TOut>
__device__ __forceinline__ void causal_swa_prime(const BlockRef<TIn, TOut>& cur, int W, char* lds, Seam<TIn>& S, const int tid_in) {
    constexpr bool F32 = same_t<TIn, float>::v;
    int tid_ = tid_in; asm volatile("" : "+v"(tid_)); __builtin_assume(tid_ >= 0 && tid_ < 512);
    const int tid = tid_, wid = __builtin_amdgcn_readfirstlane(tid >> 6), lane = tid & 63, r32 = lane & 31, hi = lane >> 5;
    const int sr = tid >> 4, sc = (tid & 15) * 8, kws = KSWZ(sr, sc * 2); char* K_lds = lds + 2 * SHM_V;
    const int kb0 = swa_jlo(cur.P0, W) * KVBLK;
    for (int d0 = 0; d0 < 8; ++d0) S.qr[d0] = load8<TIn>(cur.Q + (size_t)(wid * QBLK + r32) * D + d0 * 16 + hi * 8);
    if constexpr (F32) { SLOAD_F((const float*)cur.K, kb0); VMW(); SWRITE_KF(0); SBAR(); SLOAD_F((const float*)cur.V, kb0); }
    else { SLOAD_H(cur.K, cur.V, kb0); VMW(); SWRITE_HK(0); }
    __syncthreads();
}
template <class TIn, class TOut>
__device__ __forceinline__ void causal_swa_block(const BlockRef<TIn, TOut>& cur, const BlockRef<TIn, TOut>& nxt, int skv, int W, char* lds, Seam<TIn>& S, const int tid_in) {
    constexpr bool F32 = same_t<TIn, float>::v;
    int tid_ = tid_in; asm volatile("" : "+v"(tid_)); __builtin_assume(tid_ >= 0 && tid_ < 512);
    const int tid = tid_, wid = __builtin_amdgcn_readfirstlane(tid >> 6), lane = tid & 63, r32 = lane & 31, hi = lane >> 5;
    const int j_lo = swa_jlo(cur.P0, W);
    int j_hi = (cur.P0 + QB - 1) / KVBLK + 1; if (j_hi > skv / KVBLK) j_hi = skv / KVBLK;
    const int NT = j_hi - j_lo;
    const int kbn = swa_jlo(nxt.P0, W) * KVBLK;
    const int qlo = cur.P0 + wid * QBLK, qm = qlo + r32 - 4 * hi;
    char* V_lds = lds; char* K_lds = lds + 2 * SHM_V;
    float* ws = (float*)(lds + 2 * SHM_V + 2 * SHM_K) + wid * 64; float* li_l = ws, * al_l = ws + 32;
    float* bias_l = (float*)(lds + BIAS_OFF);
    { const int nk = cur.P0 + QB;
      for (int i = tid * 4; i < nk; i += 64 * NW * 4) *(f32x4*)(bias_l + i) = *(const f32x4*)(cur.KB + i);
      __syncthreads(); }
    float m_reg = -1e30f, l_reg = 0; f32x16 o[4] = {};
    const int sr = tid >> 4, sc = (tid & 15) * 8, vst0 = v_st(sr, sc), vst1 = v_st(32 + sr, sc), kws = KSWZ(sr, sc * 2);
    const int vb0 = (int)(uintptr_t)V_lds + v_rd_base(lane);
    const TIn* Kh = cur.K; const TIn* Vh = cur.V;
#define RESC(a) do { if (__any((a) < 1.f)) { if (hi == 0) al_l[r32] = (a); asm volatile("s_waitcnt lgkmcnt(0)" ::: "memory");              \
                     for (int d_ = 0; d_ < 4; ++d_) for (int r = 0; r < 16; ++r) o[d_][r] *= al_l[crow(r, hi)]; } } while (0)
#define KBASE(t) ((j_lo + (t)) * KVBLK)
#define ACT(t) (KBASE(t) <= qlo + QBLK - 1 && KBASE(t) + KVBLK - 1 >= qlo - W + 1)
#define MASKT(P0_, P1_, t) do { const int kb_ = KBASE(t); if ((!SK || ACT(t)) && (kb_ + KVBLK - 1 > qlo || kb_ <= qlo + QBLK - 1 - W)) mask_tile(P0_, P1_, qm - kb_, (unsigned)W); } while (0)
    constexpr int NQL = F32 ? 16 : 8;
    constexpr bool SK = WSKIP && !F32;
#define SEAM_K0() do { VMWN(NQL); if constexpr (F32) { SWRITE_KF(0); SBAR(); SLOAD_F((const float*)nxt.V, kbn); } else { SWRITE_HK(0); } SBAR(); } while (0)
    f32x16 pA0, pA1, pB0, pB1; float mnA, mnB, alA, alB; bf16x8 pa0, pa1, pa2, pa3;
    if constexpr (F32) { VMW(); SWRITE_VF(0); SBAR(); } else { SWRITE_HV(0); SBAR(); }
    if (NT > 1) { if constexpr (F32) SLOAD_F((const float*)Kh, KBASE(1)); else SLOAD_H(Kh, Vh, KBASE(1)); }
    SBAR(); qkt<0, SK>(pA0, pA1, K_lds, r32, hi, S.qr, ACT(0), bias_l + KBASE(0));
    if constexpr (F32) { if (NT > 1) { VMW(); SWRITE_KF(1); SBAR(); SLOAD_F((const float*)Vh, KBASE(1)); } }
    MASKT(pA0, pA1, 0); partialSM(pA0, pA1, m_reg, mnA, alA);
    if (NT > 1) { VMW(); if constexpr (F32) { SWRITE_VF(1); SBAR(); if (NT > 2) SLOAD_F((const float*)Kh, KBASE(2)); } else SWRITE_H(1); }
    __syncthreads();
#define HALF_STEP(PX0, PX1, mnX, alX, PY0, PY1, alY, t, KB, VB, SB) do {                                                      \
        SBAR(); qkt<KB, SK>(PX0, PX1, K_lds, r32, hi, S.qr, ACT(t), bias_l + KBASE(t));                                             \
        finishSM(PY0, PY1, alY, l_reg, pa0, pa1, pa2, pa3); SBAR();                                                           \
        if ((t) + 1 < NT) { if constexpr (F32) { VMW(); SWRITE_KF(SB); SBAR(); SLOAD_F((const float*)Vh, KBASE((t) + 1)); }  \
                            else { SLOAD_H(Kh, Vh, KBASE((t) + 1)); } SBAR(); }                                               \
        pv_tile<VB, SK>(o, vb0, pa0, pa1, pa2, pa3, ACT((t) - 1)); MASKT(PX0, PX1, (t)); partialSM(PX0, PX1, m_reg, mnX, alX);                                        \
        __syncthreads();                                                                                                      \
        if ((t) + 1 < NT) { VMW(); if constexpr (F32) { SWRITE_VF(SB); SBAR(); if ((t) + 2 < NT) SLOAD_F((const float*)Kh, KBASE((t) + 2)); } \
                            else { SWRITE_H(SB); } }                                                                          \
        RESC(alX); __syncthreads(); } while (0)
    for (int t = 1; t + 1 < NT; t += 2) {
        HALF_STEP(pB0, pB1, mnB, alB, pA0, pA1, alA, t, 1, 0, 0);
        HALF_STEP(pA0, pA1, mnA, alA, pB0, pB1, alB, t + 1, 0, 1, 1);
    }
    const bool even = (NT & 1) == 0;
    if (even) { SBAR(); qkt<1, SK>(pB0, pB1, K_lds, r32, hi, S.qr, ACT(NT - 1), bias_l + KBASE(NT - 1)); SBAR(); }
#define QROW(e) (nxt.Q + (size_t)(wid * QBLK + r32) * D + ((e) >> 1) * 16 + hi * 8 + ((e) & 1) * 4)
    if constexpr (F32) { SLOAD_F((const float*)nxt.K, kbn); SBAR();
#pragma unroll
        for (int e = 0; e < 8; ++e) S.tq[e] = *(const f32x4*)QROW(e); }
    else { SLOAD_H(nxt.K, nxt.V, kbn); SBAR();
#pragma unroll
        for (int d0 = 0; d0 < 8; ++d0) S.qr[d0] = load8<TIn>(nxt.Q + (size_t)(wid * QBLK + r32) * D + d0 * 16 + hi * 8); }
    SBAR();
    finishSM(pA0, pA1, alA, l_reg, pa0, pa1, pa2, pa3); SBAR();
    if constexpr (F32) {
#pragma unroll
        for (int e = 8; e < 16; ++e) S.tq[e] = *(const f32x4*)QROW(e); SBAR(); }
#undef QROW
    pv_tile<0, SK>(o, vb0, pa0, pa1, pa2, pa3, ACT(even ? NT - 2 : NT - 1));
    if (even) { MASKT(pB0, pB1, NT - 1); partialSM(pB0, pB1, m_reg, mnB, alB); __syncthreads(); RESC(alB);
        finishSM(pB0, pB1, alB, l_reg, pa0, pa1, pa2, pa3); SBAR(); pv_tile<1, SK>(o, vb0, pa0, pa1, pa2, pa3, ACT(NT - 1)); }
    SBAR(); SEAM_K0();
    if (hi == 0) li_l[r32] = l_reg; asm volatile("s_waitcnt lgkmcnt(0)" ::: "memory");
    float rli[16];
#pragma unroll
    for (int r = 0; r < 16; ++r) rli[r] = __builtin_amdgcn_rcpf(li_l[crow(r, hi)]);
    TOut* Ow = cur.O + (size_t)(wid * QBLK) * D;
#pragma unroll
    for (int r = 0; r < 16; ++r) { const int orow = crow(r, hi);
#pragma unroll
        for (int d0 = 0; d0 < 4; ++d0) { const float v = o[d0][r] * rli[r];
            if constexpr (same_t<TOut, float>::v) { Ow[(size_t)orow * D + d0 * 32 + r32] = v; }
            else { const float vn = __shfl_xor(v, 1);
                   if ((r32 & 1) == 0) *(unsigned*)(Ow + (size_t)orow * D + d0 * 32 + r32) = cvtpk(v, vn); } } }
    if constexpr (F32) {
#pragma unroll
        for (int d0 = 0; d0 < 8; ++d0) S.qr[d0] = pack8(S.tq[2 * d0], S.tq[2 * d0 + 1]); }
    __syncthreads();
#undef RESC
#undef KBASE
#undef ACT
#undef MASKT
#undef SEAM_K0
#undef HALF_STEP
}
#undef ROW
#undef VMW
#undef VMWN
#undef SLOAD_H
#undef SWRITE_HK
#undef SWRITE_HV
#undef SWRITE_H
#undef SLOAD_F
#undef SWRITE_KF
#undef SWRITE_VF


}
constexpr int NWAVES = 8, NTHR = NWAVES * 64;
constexpr int SEQ = 4096, DM = 4096, MTOK = 8192, DEPTH = 2;
constexpr int FH = 16, FD = 128, FW = 2048;
constexpr int GH = 4, GDK = 256, GDV = 512, GKW = 1024, GW = 2048, GR = 16, GC = 64;
constexpr int NCHUNK = SEQ / GC;
constexpr int NCROW = MTOK / GC;
constexpr int NITEM = 2 * GH * NCHUNK;
constexpr int INC = 12320, DFF = 11008;
constexpr int NPROJ_MAIN = 10240, NPROJ = 12288;
constexpr float LN_EPS = 1e-5f;
constexpr float ALPHA = 1.4142135623730951f;
constexpr float FOX_INV_SCALE = 11.313708498984761f;
constexpr size_t MiB = 1u << 20;
constexpr size_t WS_CTL = 0, CTL_ZERO_BYTES = 1 * MiB;
constexpr size_t WS_SM = 2 * MiB;
constexpr size_t WS_KBIAS = 3 * MiB;
constexpr size_t WS_DLAST = 4 * MiB;
constexpr size_t WS_WSM = 5 * MiB;
constexpr size_t WS_XB = 8 * MiB;
constexpr size_t WS_MO = 72 * MiB;
constexpr size_t WS_MIX = 200 * MiB;
constexpr size_t WS_H = 264 * MiB;
constexpr size_t WS_FQ = 264 * MiB, WS_FK = 296 * MiB, WS_FV = 328 * MiB;
constexpr size_t WS_GQ = 360 * MiB, WS_GK = 376 * MiB;
constexpr size_t WS_GG = 392 * MiB;
constexpr size_t WS_VT = 424 * MiB;
constexpr size_t WS_QT = 456 * MiB, WS_KT = 472 * MiB;
constexpr size_t WS_KDT = 488 * MiB;
constexpr size_t WS_AI = 504 * MiB;
constexpr size_t WS_UT = 512 * MiB;
constexpr size_t WS_ST = 768 * MiB;
constexpr size_t WS_OF = 896 * MiB;
constexpr size_t WS_OG = 960 * MiB;
constexpr size_t WS_WIN = 1024 * MiB;
constexpr size_t WS_WOUT = 1120 * MiB;
constexpr size_t WS_WGU = 1152 * MiB;
constexpr size_t WS_WDN = 1324 * MiB;
constexpr size_t WS_END = 1410 * MiB;
constexpr int CW_BAR = 4096;
constexpr int RING_OFF = 0, RING_BYTES = 131072;
constexpr int LDSCTL_OFF = RING_BYTES, MISC_OFF = LDSCTL_OFF + 320;
constexpr int LDS_BYTES = 147456;
static_assert(fox::LDS_BYTES <= RING_BYTES, "attention LDS");

#define GAS __attribute__((address_space(1)))
#define LAS __attribute__((address_space(3)))
typedef unsigned short bf16;
typedef unsigned v4u __attribute__((ext_vector_type(4)));
typedef unsigned v2u __attribute__((ext_vector_type(2)));
typedef float f32x4 __attribute__((ext_vector_type(4)));
typedef float f32x16 __attribute__((ext_vector_type(16)));
typedef short bf16x8 __attribute__((ext_vector_type(8)));
typedef GAS unsigned gu32;
#define RLX_AGENT __ATOMIC_RELAXED, __HIP_MEMORY_SCOPE_AGENT
#define LDS_WAIT() asm volatile("s_waitcnt lgkmcnt(0)" ::: "memory")
#define VM_WAIT() asm volatile("s_waitcnt vmcnt(0)" ::: "memory")
__device__ __forceinline__ unsigned f2bf(float f) { unsigned u = __builtin_bit_cast(unsigned, f); return (u + 0x7fffu + ((u >> 16) & 1u)) >> 16; }
__device__ __forceinline__ unsigned pk2(float lo, float hi) { return f2bf(lo) | (f2bf(hi) << 16); }
__device__ __forceinline__ float bf2f(unsigned short h) { return __builtin_bit_cast(float, (unsigned)h << 16); }
#define XB_TMO      128
#define XB_XCNT(j)  (256  + 64 * (j))
#define XB_XSUB(j)  (1280 + 64 * (j))
#define XB_XGEN(j)  (2304 + 64 * (j))
#define XB_TOP      3328
#define XB_TOPGEN   3392
#define XCD_BAR_WORDS 3456
#define XB_SPIN_CAP (1u << 18)

__device__ __forceinline__ unsigned xb_ld(unsigned* p)              { return __hip_atomic_load(p, __ATOMIC_RELAXED, __HIP_MEMORY_SCOPE_AGENT); }
__device__ __forceinline__ unsigned xb_add(unsigned* p, unsigned v) { return __hip_atomic_fetch_add(p, v, __ATOMIC_RELAXED, __HIP_MEMORY_SCOPE_AGENT); }
__device__ __forceinline__ unsigned xb_xcc_id() { return (unsigned)__builtin_amdgcn_s_getreg((3 << 11) | 20) & 0xFu; }
#define XB_SPIN(cond, bar) do { unsigned _sp = 0; while (cond) { __builtin_amdgcn_s_sleep(1); \
    if ((++_sp & 255u) == 0u) { if (xb_ld(&(bar)[XB_TMO])) break; if (_sp > XB_SPIN_CAP) { atomicAdd(&(bar)[XB_TMO], 1u); break; } } } } while (0)

struct XcdBarrier {
    unsigned* bar; unsigned x;
    volatile LAS unsigned* st;
};

__device__ __forceinline__ XcdBarrier xcd_barrier_post(unsigned* bar, volatile LAS unsigned* st, const int tid) {
    XcdBarrier b; b.bar = bar; b.x = xb_xcc_id(); b.st = st;
    if (tid == 0) (void)xb_add(&bar[XB_XCNT(b.x)], 1u);
    return b;
}
__device__ __forceinline__ void xcd_barrier_complete(unsigned* bar, unsigned x, unsigned& nloc, unsigned& nx) {
    const unsigned G = gridDim.x * gridDim.y * gridDim.z;
    unsigned sum, cnt, mine, sp = 0u;
    for (;;) {
        sum = 0u; cnt = 0u; mine = 0u;
#pragma unroll
        for (unsigned j = 0; j < 16; ++j) { const unsigned c = xb_ld(&bar[XB_XCNT(j)]); sum += c; cnt += (c > 0u) ? 1u : 0u; mine = (j == x) ? c : mine; }
        if (sum == G) break;
        __builtin_amdgcn_s_sleep(1);
        if ((++sp & 255u) == 0u) { if (xb_ld(&bar[XB_TMO])) break; if (sp > XB_SPIN_CAP) { atomicAdd(&bar[XB_TMO], 1u); break; } }
    }
    nloc = mine > 0u ? mine : 1u; nx = cnt > 0u ? cnt : 1u;
}

__device__ __forceinline__ void xcd_barrier(const XcdBarrier& b, const int tid) {
    asm volatile("s_waitcnt vmcnt(0)" ::: "memory");
    __syncthreads();
    if (tid == 0) {
        unsigned* bar = b.bar;
        __builtin_amdgcn_s_waitcnt(0);
        unsigned nloc = b.st[0], nx = b.st[1];
        if (nloc == 0u) { xcd_barrier_complete(bar, b.x, nloc, nx); b.st[0] = nloc; b.st[1] = nx; }
        const unsigned old = xb_add(&bar[XB_XSUB(b.x)], 1u);
        const unsigned gen = old / nloc;
        if (old + 1u == (gen + 1u) * nloc) {
            __builtin_amdgcn_fence(__ATOMIC_RELEASE, "agent");
            asm volatile("s_waitcnt vmcnt(0)" ::: "memory");
            const unsigned og = xb_add(&bar[XB_TOP], 1u);
            const unsigned tg = og / nx;
            if (og + 1u == (tg + 1u) * nx) xb_add(&bar[XB_TOPGEN], 1u);
            else XB_SPIN(xb_ld(&bar[XB_TOPGEN]) == tg, bar);
            __builtin_amdgcn_fence(__ATOMIC_ACQUIRE, "agent");
            xb_add(&bar[XB_XGEN(b.x)], 1u);
            asm volatile("s_waitcnt vmcnt(0)" ::: "memory");
        } else {
            XB_SPIN(xb_ld(&bar[XB_XGEN(b.x)]) == gen, bar);
            __builtin_amdgcn_fence(__ATOMIC_ACQUIRE, "agent");
            asm volatile("s_waitcnt vmcnt(0)" ::: "memory");
        }
    }
    __syncthreads();
}
struct Frame {
    LAS unsigned char* lds;
    int tid, lane, wave;
    int G, bid;
    unsigned char* ws;
    float* X;
    bf16* XB;
};
__device__ __forceinline__ float wave_sum(float v) {
#pragma unroll
    for (int o = 1; o < 64; o <<= 1) v += __shfl_xor(v, o);
    return v;
}
template <int MODE>
__device__ __forceinline__ void ln_rows(Frame& F, const float* xin, const float* add, const float* g, const float* b) {
    const int gw = F.bid * NWAVES + F.wave, NGW = F.G * NWAVES;
    for (int m = gw; m < MTOK; m += NGW) {
        const f32x4* xr = (const f32x4*)((MODE == 0 ? xin : F.X) + (size_t)m * DM) + F.lane;
        f32x4 v[16]; float s = 0.f;
        if (MODE == 0) {
#pragma unroll
            for (int j = 0; j < 16; ++j) v[j] = xr[64 * j];
        } else {
            const f32x4* ar = (const f32x4*)(add + (size_t)m * DM) + F.lane;
#pragma unroll
            for (int j = 0; j < 16; ++j) v[j] = xr[64 * j] * ALPHA + ar[64 * j];
        }
#pragma unroll
        for (int j = 0; j < 16; ++j) s += (v[j].x + v[j].y) + (v[j].z + v[j].w);
        const float mean = wave_sum(s) * (1.f / DM); float s2 = 0.f;
#pragma unroll
        for (int j = 0; j < 16; ++j) { v[j] = v[j] - mean; s2 += (v[j].x * v[j].x + v[j].y * v[j].y) + (v[j].z * v[j].z + v[j].w * v[j].w); }
        const float rstd = 1.f / sqrtf(wave_sum(s2) * (1.f / DM) + LN_EPS);
        f32x4* xo = (f32x4*)(F.X + (size_t)m * DM) + F.lane;
        v2u* bo = (v2u*)(F.XB + (size_t)m * DM) + F.lane;
        const f32x4* gp = (const f32x4*)g + F.lane; const f32x4* bp = (const f32x4*)b + F.lane;
#pragma unroll
        for (int j = 0; j < 16; ++j) { const f32x4 o = v[j] * rstd * gp[64 * j] + bp[64 * j]; xo[64 * j] = o; v2u w; w.x = pk2(o.x, o.y); w.y = pk2(o.z, o.w); bo[64 * j] = w; }
    }
}
__device__ __forceinline__ void tr_item(const float* W, int ldw, int K, bf16* WT, int k0, int c0, int r0, LAS float* scr, int lane) {
#pragma unroll 8
    for (int i = 0; i < 32; ++i) { const int kk = 2 * i + (lane >> 5); scr[kk * 33 + (lane & 31)] = W[(size_t)(k0 + kk) * ldw + c0 + (lane & 31)]; }
    LDS_WAIT(); asm volatile("" ::: "memory");
    const int c = lane & 7;
#pragma unroll
    for (int j = 0; j < 4; ++j) { const int n = (lane >> 3) + 8 * j; const LAS float* s = scr + (8 * c) * 33 + n;
        v4u o; o.x = pk2(s[0 * 33], s[1 * 33]); o.y = pk2(s[2 * 33], s[3 * 33]); o.z = pk2(s[4 * 33], s[5 * 33]); o.w = pk2(s[6 * 33], s[7 * 33]);
        *(v4u*)(WT + (size_t)(r0 + n) * K + k0 + 8 * c) = o; }
    LDS_WAIT(); asm volatile("" ::: "memory");
}
__device__ __forceinline__ void p_convert(Frame& F, const float* w_in, const float* w_out, const float* w_gate, const float* w_up, const float* w_down) {
    LAS float* scr = (LAS float*)(F.lds + RING_OFF + F.wave * 16384);
    const int gw = F.bid * NWAVES + F.wave, NGW = F.G * NWAVES;
    bf16* WIN = (bf16*)(F.ws + WS_WIN); bf16* WOUT = (bf16*)(F.ws + WS_WOUT); bf16* WGU = (bf16*)(F.ws + WS_WGU); bf16* WDN = (bf16*)(F.ws + WS_WDN);
    constexpr int I_IN = (NPROJ / 32) * (DM / 64), I_OUT = (DM / 32) * (DM / 64), I_GU = (2 * DFF / 32) * (DM / 64), I_DN = (DM / 32) * (DFF / 64);
    constexpr int NITEMS = I_IN + I_OUT + I_GU + I_DN;
    for (int it = gw; it < NITEMS; it += NGW) {
        int r = it;
        if (r < I_IN) { const int rb = r % (NPROJ / 32), kb = r / (NPROJ / 32), r0 = 32 * rb;
            const int c0 = r0 < 6144 ? r0 : (r0 < 8192 ? r0 + 16 : (r0 < 10240 ? r0 + 2064 : r0 - 2032));
            tr_item(w_in, INC, DM, WIN, 64 * kb, c0, r0, scr, F.lane); continue; }
        r -= I_IN;
        if (r < I_OUT) { const int rb = r % (DM / 32), kb = r / (DM / 32); tr_item(w_out, DM, DM, WOUT, 64 * kb, 32 * rb, 32 * rb, scr, F.lane); continue; }
        r -= I_OUT;
        if (r < I_GU) { const int rb = r % (2 * DFF / 32), kb = r / (2 * DFF / 32), r0 = 32 * rb, j = r0 >> 8, within = r0 & 255;
            if (within < 128) tr_item(w_gate, DFF, DM, WGU, 64 * kb, 128 * j + within, r0, scr, F.lane);
            else tr_item(w_up, DFF, DM, WGU, 64 * kb, 128 * j + within - 128, r0, scr, F.lane);
            continue; }
        r -= I_GU;
        { const int rb = r % (DM / 32), kb = r / (DM / 32); tr_item(w_down, DM, DFF, WDN, 64 * kb, 32 * rb, 32 * rb, scr, F.lane); }
    }
    bf16* WSM = (bf16*)(F.ws + WS_WSM);
    for (int idx = F.bid * NTHR + F.tid; idx < 32 * DM; idx += F.G * NTHR) { const int k = idx >> 5, n = idx & 31; const int c = n < 16 ? 6144 + n : 12304 + (n - 16);
        WSM[(size_t)n * DM + k] = (bf16)f2bf(w_in[(size_t)k * INC + c]); }
}
__device__ __forceinline__ f32x16 tile_kc(const bf16* A, int lda, const bf16* B, int ldb, int ksteps, f32x16 acc, int lane) {
    const bf16* ap = A + (size_t)(lane & 31) * lda + 8 * (lane >> 5); const bf16* bp = B + (size_t)(lane & 31) * ldb + 8 * (lane >> 5);
    for (int ks = 0; ks < ksteps; ++ks) { const bf16x8 a = *(const bf16x8*)(ap + 16 * ks), b = *(const bf16x8*)(bp + 16 * ks);
        acc = __builtin_amdgcn_mfma_f32_32x32x16_bf16(a, b, acc, 0, 0, 0); }
    return acc;
}
__device__ __forceinline__ int crow(int r, int hi) { return (r & 3) + 8 * (r >> 2) + 4 * hi; }
__device__ __forceinline__ void p_small_proj(Frame& F) {
    const bf16* WSM = (const bf16*)(F.ws + WS_WSM); float* SM = (float*)(F.ws + WS_SM);
    LAS float* part = (LAS float*)(F.lds + RING_OFF);
    for (int t = F.bid; t < MTOK / 32; t += F.G) {
        f32x16 acc = {};
        acc = tile_kc(F.XB + (size_t)t * 32 * DM + F.wave * 512, DM, WSM + F.wave * 512, DM, 32, acc, F.lane);
#pragma unroll
        for (int r = 0; r < 16; ++r) part[(F.wave * 16 + r) * 64 + F.lane] = acc[r];
        __syncthreads();
#pragma unroll
        for (int q = 0; q < 2; ++q) { const int idx = F.tid + NTHR * q, r = idx >> 6, l = idx & 63; float s = 0.f;
#pragma unroll
            for (int w = 0; w < 8; ++w) s += part[(w * 16 + r) * 64 + l];
            SM[(size_t)(t * 32 + crow(r, l >> 5)) * 32 + (l & 31)] = s; }
        __syncthreads();
    }
}
__device__ __forceinline__ float log_sigmoid(float z) { return fminf(z, 0.f) - log1pf(expf(-fabsf(z))); }
__device__ __forceinline__ void p_prep(Frame& F, const float* b_f, const float* w_gk_up, const float* b_gk) {
    const float* SM = (const float*)(F.ws + WS_SM);
    { float* KBIAS = (float*)(F.ws + WS_KBIAS);
      for (int q = F.bid * NWAVES + F.wave; q < 32; q += F.G * NWAVES) { const int b = q >> 4, h = q & 15; const float bf = b_f[h];
          const float* src = SM + (size_t)(b * SEQ + F.lane * 64) * 32 + h;
          double run = 0.0;
          for (int i = 0; i < 64; ++i) run += (double)log_sigmoid(src[(size_t)i * 32] + bf);
          double incl = run;
#pragma unroll
          for (int o = 1; o < 64; o <<= 1) { const double up = __shfl_up(incl, o); if (F.lane >= o) incl += up; }
          double c = incl - run;
          float* dst = KBIAS + (size_t)q * SEQ + F.lane * 64;
          for (int i = 0; i < 64; ++i) { c += (double)log_sigmoid(src[(size_t)i * 32] + bf); dst[i] = (float)(-c * (double)FOX_INV_SCALE); } } }
    { const bf16* GQ = (const bf16*)(F.ws + WS_GQ); const bf16* GK = (const bf16*)(F.ws + WS_GK);
      bf16* QT = (bf16*)(F.ws + WS_QT); bf16* KT = (bf16*)(F.ws + WS_KT); bf16* KDT = (bf16*)(F.ws + WS_KDT); float* DLAST = (float*)(F.ws + WS_DLAST);
      for (int g = F.bid * NTHR + F.tid; g < NCROW * GKW; g += F.G * NTHR) { const int cr = g >> 10, dc = g & 1023;
          float w[16];
#pragma unroll
          for (int r = 0; r < 16; ++r) w[r] = w_gk_up[r * GKW + dc];
          const float bg = b_gk[dc];
          float blast = 0.f;
#pragma unroll 4
          for (int j = 0; j < 64; ++j) { const f32x4* gl = (const f32x4*)(SM + (size_t)(cr * 64 + j) * 32 + 16);
              const f32x4 g0 = gl[0], g1 = gl[1], g2 = gl[2], g3 = gl[3];
              float z = bg;
              z += g0.x * w[0] + g0.y * w[1] + g0.z * w[2] + g0.w * w[3]; z += g1.x * w[4] + g1.y * w[5] + g1.z * w[6] + g1.w * w[7];
              z += g2.x * w[8] + g2.y * w[9] + g2.z * w[10] + g2.w * w[11]; z += g3.x * w[12] + g3.y * w[13] + g3.z * w[14] + g3.w * w[15];
              blast += log_sigmoid(z) * (1.f / 16.f); }
          DLAST[(size_t)cr * GKW + dc] = expf(blast);
          bf16* kd = KDT + ((size_t)cr * GKW + dc) * 64;
          float run = 0.f;
          for (int j8 = 0; j8 < 8; ++j8) { float kv[8];
#pragma unroll
              for (int e = 0; e < 8; ++e) { const int j = j8 * 8 + e; const size_t off = (size_t)(cr * 64 + j) * GKW + dc;
                  const f32x4* gl = (const f32x4*)(SM + (size_t)(cr * 64 + j) * 32 + 16);
                  const f32x4 g0 = gl[0], g1 = gl[1], g2 = gl[2], g3 = gl[3];
                  float z = bg;
                  z += g0.x * w[0] + g0.y * w[1] + g0.z * w[2] + g0.w * w[3]; z += g1.x * w[4] + g1.y * w[5] + g1.z * w[6] + g1.w * w[7];
                  z += g2.x * w[8] + g2.y * w[9] + g2.z * w[10] + g2.w * w[11]; z += g3.x * w[12] + g3.y * w[13] + g3.z * w[14] + g3.w * w[15];
                  run += log_sigmoid(z) * (1.f / 16.f);
                  const float qv = bf2f(GQ[off]), kk = bf2f(GK[off]), bj = run;
                  QT[off] = (bf16)f2bf(qv * 0.0625f * expf(bj)); KT[off] = (bf16)f2bf(kk * expf(-bj)); kv[e] = kk * expf(blast - bj); }
              v4u o; o.x = pk2(kv[0], kv[1]); o.y = pk2(kv[2], kv[3]); o.z = pk2(kv[4], kv[5]); o.w = pk2(kv[6], kv[7]);
              *(v4u*)(kd + j8 * 8) = o; } } }
}
__device__ __forceinline__ void p_gla_local(Frame& F) {
    const bf16* QT = (const bf16*)(F.ws + WS_QT); const bf16* KT = (const bf16*)(F.ws + WS_KT); const bf16* KDT = (const bf16*)(F.ws + WS_KDT); const bf16* VT = (const bf16*)(F.ws + WS_VT);
    bf16* AI = (bf16*)(F.ws + WS_AI); float* UT = (float*)(F.ws + WS_UT);
    const int c = F.lane & 31, hi = F.lane >> 5;
    for (int it = F.bid; it < NITEM; it += F.G) { const int b = it >> 8, h = (it >> 6) & 3, n = it & 63; const int t0 = b * SEQ + n * 64, cr = b * 64 + n;
        if (F.wave < 4) { const int ti = F.wave >> 1, tj = F.wave & 1; f32x16 acc = {};
            if (tj <= ti) acc = tile_kc(QT + (size_t)(t0 + 32 * ti) * GKW + h * GDK, GKW, KT + (size_t)(t0 + 32 * tj) * GKW + h * GDK, GKW, 16, acc, F.lane);
            bf16* ao = AI + (size_t)it * 4096;
#pragma unroll
            for (int r = 0; r < 16; ++r) { const int i = 32 * ti + crow(r, hi), j = 32 * tj + c; ao[i * 64 + j] = (bf16)f2bf(j <= i ? acc[r] : 0.f); } }
        for (int et = 2 * F.wave; et < 2 * F.wave + 2; ++et) { const bf16* va = VT + (size_t)(h * GDV + 32 * et) * MTOK + t0;
            for (int dt = 0; dt < 8; ++dt) { f32x16 acc = {};
                acc = tile_kc(va, MTOK, KDT + ((size_t)cr * GKW + h * GDK + 32 * dt) * 64, 64, 4, acc, F.lane);
                float* uo = UT + ((size_t)it * GDV + 32 * et) * GDK + 32 * dt;
#pragma unroll
                for (int r = 0; r < 16; ++r) uo[(size_t)crow(r, hi) * GDK + c] = acc[r]; } }
    }
}
__device__ __forceinline__ void p_gla_scan(Frame& F) {
    const float* UT = (const float*)(F.ws + WS_UT); const float* DLAST = (const float*)(F.ws + WS_DLAST); bf16* ST = (bf16*)(F.ws + WS_ST);
    for (int g = F.bid * NTHR + F.tid; g < 8 * GDV * (GDK / 4); g += F.G * NTHR) { const int d4 = g & 63, e = (g >> 6) & 511, bh = g >> 15, b = bh >> 2, h = bh & 3;
        f32x4 s = {0.f, 0.f, 0.f, 0.f};
        for (int n = 0; n < NCHUNK; ++n) { const size_t off = ((size_t)(bh * 64 + n) * GDV + e) * GDK + 4 * d4;
            const f32x4 u = *(const f32x4*)(UT + off); const f32x4 dl = *(const f32x4*)(DLAST + (size_t)(b * 64 + n) * GKW + h * GDK + 4 * d4);
            v2u w; w.x = pk2(s.x, s.y); w.y = pk2(s.z, s.w); *(v2u*)(ST + off) = w;
            s = dl * s + u; } }
}
__device__ __forceinline__ void p_gla_out(Frame& F) {
    const bf16* QT = (const bf16*)(F.ws + WS_QT); const bf16* AI = (const bf16*)(F.ws + WS_AI); const bf16* ST = (const bf16*)(F.ws + WS_ST); const bf16* VT = (const bf16*)(F.ws + WS_VT);
    float* OG = (float*)(F.ws + WS_OG);
    const int c = F.lane & 31, hi = F.lane >> 5;
    for (int it = F.bid; it < NITEM; it += F.G) { const int b = it >> 8, h = (it >> 6) & 3, n = it & 63; const int t0 = b * SEQ + n * 64;
        for (int et = 2 * F.wave; et < 2 * F.wave + 2; ++et)
            for (int ti = 0; ti < 2; ++ti) { f32x16 acc = {};
                acc = tile_kc(QT + (size_t)(t0 + 32 * ti) * GKW + h * GDK, GKW, ST + ((size_t)it * GDV + 32 * et) * GDK, GDK, 16, acc, F.lane);
                acc = tile_kc(AI + (size_t)it * 4096 + 32 * ti * 64, 64, VT + (size_t)(h * GDV + 32 * et) * MTOK + t0, MTOK, 4, acc, F.lane);
                float* oo = OG + (size_t)(t0 + 32 * ti) * GW + h * GDV + 32 * et;
#pragma unroll
                for (int r = 0; r < 16; ++r) oo[(size_t)crow(r, hi) * GW + c] = acc[r]; }
    }
}
__device__ __forceinline__ void p_norm_gate(Frame& F, const float* fox_g, const float* gla_g) {
    const float* OF = (const float*)(F.ws + WS_OF); const float* OG = (const float*)(F.ws + WS_OG); const bf16* GG = (const bf16*)(F.ws + WS_GG); bf16* MIX = (bf16*)(F.ws + WS_MIX);
    const int gw = F.bid * NWAVES + F.wave, NGW = F.G * NWAVES;
    for (int m = gw; m < MTOK; m += NGW) { const int b = m >> 12, s = m & 4095;
        { const int h = F.lane >> 2, part = F.lane & 3;
          const f32x4* src = (const f32x4*)(OF + ((size_t)(b * 16 + h) * SEQ + s) * 128 + part * 32);
          f32x4 v[8]; float ss = 0.f;
#pragma unroll
          for (int j = 0; j < 8; ++j) { v[j] = src[j]; ss += (v[j].x * v[j].x + v[j].y * v[j].y) + (v[j].z * v[j].z + v[j].w * v[j].w); }
          ss += __shfl_xor(ss, 1); ss += __shfl_xor(ss, 2);
          const float rstd = 1.f / sqrtf(ss * (1.f / 128.f) + LN_EPS);
          const f32x4* gp = (const f32x4*)(fox_g + h * 128 + part * 32);
          v4u* dst = (v4u*)(MIX + (size_t)m * DM + h * 128 + part * 32);
#pragma unroll
          for (int j = 0; j < 4; ++j) { const f32x4 a = v[2 * j] * rstd * gp[2 * j], c2 = v[2 * j + 1] * rstd * gp[2 * j + 1];
              v4u o; o.x = pk2(a.x, a.y); o.y = pk2(a.z, a.w); o.z = pk2(c2.x, c2.y); o.w = pk2(c2.z, c2.w); dst[j] = o; } }
        { const int h = F.lane >> 4, part = F.lane & 15;
          const f32x4* src = (const f32x4*)(OG + (size_t)m * GW + h * GDV + part * 32);
          f32x4 v[8]; float ss = 0.f;
#pragma unroll
          for (int j = 0; j < 8; ++j) { v[j] = src[j]; ss += (v[j].x * v[j].x + v[j].y * v[j].y) + (v[j].z * v[j].z + v[j].w * v[j].w); }
          ss += __shfl_xor(ss, 1); ss += __shfl_xor(ss, 2); ss += __shfl_xor(ss, 4); ss += __shfl_xor(ss, 8);
          const float rstd = 1.f / sqrtf(ss * (1.f / 512.f) + LN_EPS);
          const f32x4* gp = (const f32x4*)(gla_g + part * 32);
          const v4u* gg = (const v4u*)(GG + (size_t)m * GW + h * GDV + part * 32);
          v4u* dst = (v4u*)(MIX + (size_t)m * DM + FW + h * GDV + part * 32);
#pragma unroll
          for (int j = 0; j < 4; ++j) { const v4u gr = gg[j]; float gt[8];
              gt[0] = __builtin_bit_cast(float, gr.x << 16); gt[1] = __builtin_bit_cast(float, gr.x & 0xffff0000u); gt[2] = __builtin_bit_cast(float, gr.y << 16); gt[3] = __builtin_bit_cast(float, gr.y & 0xffff0000u);
              gt[4] = __builtin_bit_cast(float, gr.z << 16); gt[5] = __builtin_bit_cast(float, gr.z & 0xffff0000u); gt[6] = __builtin_bit_cast(float, gr.w << 16); gt[7] = __builtin_bit_cast(float, gr.w & 0xffff0000u);
              float ov[8]; const f32x4 a = v[2 * j] * rstd * gp[2 * j], c2 = v[2 * j + 1] * rstd * gp[2 * j + 1];
              ov[0] = a.x; ov[1] = a.y; ov[2] = a.z; ov[3] = a.w; ov[4] = c2.x; ov[5] = c2.y; ov[6] = c2.z; ov[7] = c2.w;
#pragma unroll
              for (int e = 0; e < 8; ++e) ov[e] *= gt[e] / (1.f + expf(-gt[e]));
              v4u o; o.x = pk2(ov[0], ov[1]); o.y = pk2(ov[2], ov[3]); o.z = pk2(ov[4], ov[5]); o.w = pk2(ov[6], ov[7]); dst[j] = o; } }
    }
}
__device__ __forceinline__ fox::BlockRef<fox::TIN, fox::TOUT> fox_ref(const fox::TIN* Q, const fox::TIN* K, const fox::TIN* V, float* O, const float* KBIAS, int item, int ps) {
    const int bh = item >> 3, y = item & 7, qb = ps ? 15 - y : y; fox::BlockRef<fox::TIN, fox::TOUT> r;
    r.Q = Q + ((size_t)bh * SEQ + (size_t)qb * fox::QB) * 128; r.O = O + ((size_t)bh * SEQ + (size_t)qb * fox::QB) * 128;
    r.K = K + (size_t)bh * SEQ * 128; r.V = V + (size_t)bh * SEQ * 128; r.P0 = qb * fox::QB; r.KB = KBIAS + (size_t)bh * SEQ; return r;
}
__device__ __forceinline__ void p_fox_attn(Frame& F, char* lds) {
    using BR = fox::BlockRef<fox::TIN, fox::TOUT>;
    const fox::TIN* Q = (const fox::TIN*)(F.ws + WS_FQ); const fox::TIN* K = (const fox::TIN*)(F.ws + WS_FK); const fox::TIN* V = (const fox::TIN*)(F.ws + WS_FV);
    float* O = (float*)(F.ws + WS_OF); const float* KBIAS = (const float*)(F.ws + WS_KBIAS);
    constexpr int NX = 8, TOTAL = 32 * NX;
    int L = F.bid; if (L >= TOTAL) return;
    int pass = 0;
    BR cur = fox_ref(Q, K, V, O, KBIAS, L, 0);
    fox::Seam<fox::TIN> S;
    fox::causal_swa_prime<fox::TIN, fox::TOUT>(cur, SEQ, lds, S, F.tid);
    for (;;) {
        const bool more_pass = pass == 0, more_item = L + F.G < TOTAL, last = !more_pass && !more_item;
        int passn = pass + 1, Ln = L;
        if (!more_pass) { passn = 0; Ln = more_item ? L + F.G : L; }
        const BR nxt = last ? cur : fox_ref(Q, K, V, O, KBIAS, Ln, passn);
        fox::causal_swa_block<fox::TIN, fox::TOUT>(cur, nxt, SEQ, SEQ, lds, S, F.tid);
        if (last) break;
        cur = nxt; pass = passn; L = Ln;
    }
}
struct Args { const float* in[17]; float* out; unsigned char* ws; int ph_lo, ph_hi; };
constexpr int PH_PER_LAYER = 12, N_PHASES = 1 + DEPTH * PH_PER_LAYER;
#ifndef MK_N_LAUNCHES
#define MK_N_LAUNCHES 1
#endif
#ifndef PHMASK
#define PHMASK 0xFFFF
#endif
#ifndef SUBMASK
#define SUBMASK 0xFF
#endif
#define ON(j) ((PHMASK >> (j)) & 1)
#define SUB(j) ((SUBMASK >> (j)) & 1)
__device__ __forceinline__ unsigned long long karg_get(int i) {
    unsigned long long v; const unsigned long long kp = (unsigned long long)__builtin_amdgcn_kernarg_segment_ptr();
    asm volatile("s_load_dwordx2 %0, %1, %2\n\ts_waitcnt lgkmcnt(0)" : "=s"(v) : "s"(kp), "i"(8 * i) : "memory");
    return v;
}
#define TIN(i) ((const float*)(const GAS float*)karg_get(i))
#define PH_BEGIN() do { { int ln_; asm volatile("v_mbcnt_lo_u32_b32 %0, -1, 0\n\tv_mbcnt_hi_u32_b32 %0, -1, %0" : "=v"(ln_)); F.lane = ln_; F.tid = (F.wave << 6) | ln_; int g_ = gridDim.x, b_ = blockIdx.x; asm volatile("" : "+s"(g_), "+s"(b_)); F.G = g_; F.bid = b_; } F.ws = (unsigned char*)(GAS unsigned char*)karg_get(18); F.X = (float*)(GAS float*)karg_get(17); F.XB = (bf16*)(F.ws + WS_XB); } while (0)
#define LAYER_BODY(l) { \
        const int p0 = 1 + l * PH_PER_LAYER; \
        if (ON(1) && IN(p0 + 0)) { PH_BEGIN(); p_convert(F, TIN(3) + (size_t)l * DM * INC, TIN(9) + (size_t)l * DM * DM, TIN(12) + (size_t)l * DM * DFF, TIN(13) + (size_t)l * DM * DFF, TIN(14) + (size_t)l * DFF * DM); } \
        SEAM(p0 + 0); \
        if (ON(2) && IN(p0 + 1)) { PH_BEGIN(); \
            if (SUB(0)) { pg8::Gemm g{F.XB, (const bf16*)(F.ws + WS_WIN), MTOK, NPROJ_MAIN, DM}; pg8::StaticOrder S; S.init(MTOK, NPROJ_MAIN, F.G, F.bid); \
              pg8::EpiProj E{F.ws}; \
              pg8::gemm_phase<pg8::EpiProj, pg8::StaticOrder, true, true>(F.lds + RING_OFF, g, S, E, F.tid); } \
            if (SUB(1)) { pg8::Gemm g{(const bf16*)(F.ws + WS_WIN) + (size_t)NPROJ_MAIN * DM, F.XB, GW, MTOK, DM}; pg8::StaticOrder S; S.init(GW, MTOK, F.G, F.bid); \
              pg8::EpiBf16Plain E{(bf16*)(F.ws + WS_VT), MTOK}; \
              pg8::gemm_phase<pg8::EpiBf16Plain, pg8::StaticOrder, true, true>(F.lds + RING_OFF, g, S, E, F.tid); } \
            if (SUB(2)) p_small_proj(F); \
        } \
        SEAM(p0 + 1); \
        if (ON(3) && IN(p0 + 2)) { PH_BEGIN(); p_prep(F, TIN(4) + l * FH, TIN(5) + (size_t)l * GR * GKW, TIN(6) + l * GKW); } \
        SEAM(p0 + 2); \
        if (ON(4) && IN(p0 + 3)) { PH_BEGIN(); if (SUB(0)) p_fox_attn(F, (char*)lds + RING_OFF); if (SUB(1)) p_gla_local(F); } \
        SEAM(p0 + 3); \
        if (ON(5) && IN(p0 + 4)) { PH_BEGIN(); p_gla_scan(F); } \
        SEAM(p0 + 4); \
        if (ON(6) && IN(p0 + 5)) { PH_BEGIN(); p_gla_out(F); } \
        SEAM(p0 + 5); \
        if (ON(7) && IN(p0 + 6)) { PH_BEGIN(); p_norm_gate(F, TIN(7) + l * FH * FD, TIN(8) + l * GDV); } \
        SEAM(p0 + 6); \
        if (ON(8) && IN(p0 + 7)) { PH_BEGIN(); pg8::Gemm g{(const bf16*)(F.ws + WS_MIX), (const bf16*)(F.ws + WS_WOUT), MTOK, DM, DM}; pg8::StaticOrder S; S.init(MTOK, DM, F.G, F.bid); \
            pg8::EpiF32 E{(float*)(F.ws + WS_MO), DM}; \
            pg8::gemm_phase<pg8::EpiF32, pg8::StaticOrder, true, true>(F.lds + RING_OFF, g, S, E, F.tid); } \
        SEAM(p0 + 7); \
        if (ON(9) && IN(p0 + 8)) { PH_BEGIN(); ln_rows<1>(F, nullptr, (const float*)(F.ws + WS_MO), TIN(10) + l * DM, TIN(11) + l * DM); } \
        SEAM(p0 + 8); \
        if (ON(10) && IN(p0 + 9)) { PH_BEGIN(); pg8::Gemm g{F.XB, (const bf16*)(F.ws + WS_WGU), MTOK, 2 * DFF, DM}; pg8::StaticOrder S; S.init(MTOK, 2 * DFF, F.G, F.bid); \
            pg8::EpiSwiglu E{(bf16*)(F.ws + WS_H), DFF}; \
            pg8::gemm_phase<pg8::EpiSwiglu, pg8::StaticOrder, true, true>(F.lds + RING_OFF, g, S, E, F.tid); } \
        SEAM(p0 + 9); \
        if (ON(11) && IN(p0 + 10)) { PH_BEGIN(); pg8::Gemm g{(const bf16*)(F.ws + WS_H), (const bf16*)(F.ws + WS_WDN), MTOK, DM, DFF}; pg8::StaticOrder S; S.init(MTOK, DM, F.G, F.bid); \
            pg8::EpiF32 E{(float*)(F.ws + WS_MO), DM}; \
            pg8::gemm_phase<pg8::EpiF32, pg8::StaticOrder, true, true>(F.lds + RING_OFF, g, S, E, F.tid); } \
        SEAM(p0 + 10); \
        if (ON(12) && IN(p0 + 11)) { PH_BEGIN(); ln_rows<1>(F, nullptr, (const float*)(F.ws + WS_MO), TIN(15) + l * DM, TIN(16) + l * DM); } \
        SEAM(p0 + 11); \
    }
__global__ void __launch_bounds__(NTHR, 2) mk_fwd(Args args) {
    extern __shared__ __attribute__((aligned(16))) unsigned char lds[];
    Frame F;
    F.lds = (LAS unsigned char*)lds;
    F.tid = threadIdx.x; F.lane = F.tid & 63; F.wave = __builtin_amdgcn_readfirstlane(F.tid >> 6);
    F.G = gridDim.x; F.bid = blockIdx.x;
    for (int u = F.tid; u < (LDS_BYTES - LDSCTL_OFF) / 4; u += NTHR) ((LAS unsigned*)(F.lds + LDSCTL_OFF))[u] = 0u;
    __syncthreads();
    { unsigned* bw = (unsigned*)((unsigned char*)(GAS unsigned char*)karg_get(18) + WS_CTL) + CW_BAR; (void)xcd_barrier_post(bw, (volatile LAS unsigned*)(F.lds + MISC_OFF) + 8, F.tid); }
#if MK_N_LAUNCHES == 1
    constexpr int lo = 0, hi = N_PHASES;
#else
    const int lo = args.ph_lo, hi = args.ph_hi;
#endif
#define IN(k) (lo <= (k) && (k) < hi)
#define SEAM(k) do { if (IN(k) && IN((k) + 1)) { XcdBarrier bar_; bar_.bar = (unsigned*)((unsigned char*)(GAS unsigned char*)karg_get(18) + WS_CTL) + CW_BAR; bar_.x = xb_xcc_id(); bar_.st = (volatile LAS unsigned*)(F.lds + MISC_OFF) + 8; { int ln_; asm volatile("v_mbcnt_lo_u32_b32 %0, -1, 0\n\tv_mbcnt_hi_u32_b32 %0, -1, %0" : "=v"(ln_)); xcd_barrier(bar_, (F.wave << 6) | ln_); } } } while (0)
    if (ON(0) && IN(0)) { PH_BEGIN(); ln_rows<0>(F, TIN(0), nullptr, TIN(1), TIN(2)); }
    SEAM(0);
    LAYER_BODY(0)
    LAYER_BODY(1)
#undef IN
#undef SEAM
}

extern "C" void kernel_launch(void* const* d_in, const int* in_sizes, int n_in, void* d_out, int out_size, void* d_ws, size_t ws_size, hipStream_t stream) {
    static int grid = 0;
    if (grid == 0) {
        if (n_in != 17 || out_size != MTOK * DM || ws_size < WS_END) { fprintf(stderr, "kernel_launch: unexpected shapes (n_in %d, out %d, ws %zu < %zu); nothing launched\n", n_in, out_size, ws_size, (size_t)WS_END); grid = -1; return; }
        int dev = 0, cus = 0, per_cu = 0;
        if (hipGetDevice(&dev) != hipSuccess || hipDeviceGetAttribute(&cus, hipDeviceAttributeMultiprocessorCount, dev) != hipSuccess) { grid = -1; return; }
        if (hipFuncSetAttribute((const void*)mk_fwd, hipFuncAttributeMaxDynamicSharedMemorySize, LDS_BYTES) != hipSuccess) { fprintf(stderr, "kernel_launch: hipFuncSetAttribute failed\n"); grid = -1; return; }
        if (hipOccupancyMaxActiveBlocksPerMultiprocessor(&per_cu, (const void*)mk_fwd, NTHR, LDS_BYTES) != hipSuccess || per_cu < 1) fprintf(stderr, "kernel_launch: occupancy query reports %d\n", per_cu);
        (void)hipGetLastError();
        grid = cus;
    }
    if (grid < 0) return;
    if (hipMemsetAsync((char*)d_ws + WS_CTL, 0, CTL_ZERO_BYTES, stream) != hipSuccess) return;
    Args a{};
    for (int i = 0; i < 17; ++i) a.in[i] = (const float*)d_in[i];
    a.out = (float*)d_out; a.ws = (unsigned char*)d_ws;
#if MK_N_LAUNCHES == 1
    a.ph_lo = 0; a.ph_hi = N_PHASES;
    hipLaunchKernelGGL(mk_fwd, dim3(grid), dim3(NTHR), LDS_BYTES, stream, a);
#else
    for (int p = 0; p < N_PHASES; ++p) { a.ph_lo = p; a.ph_hi = p + 1; hipLaunchKernelGGL(mk_fwd, dim3(grid), dim3(NTHR), LDS_BYTES, stream, a); }
#endif
}
```
